# Optimizing an MI355X kernel written in HIP

```python
import math
import jax, jax.numpy as jnp
from jax import lax
import numpy as np

D_MODEL = 4096
BATCH = 2
SEQ = 4096
DEPTH = 1
DEC_BATCH = 128
DEC_SEQ = 8
PAST_LEN = 8192
PAGE_SIZE = 128

POOL_WIDTH = D_MODEL // 2
POOL_WINDOWS = (2, 4, 8, 16)
POOL_GROUPS = len(POOL_WINDOWS)
POOL_GROUP_WIDTH = POOL_WIDTH // POOL_GROUPS
POOL_STATE = max(POOL_WINDOWS) - 1
HEAD_DIM = 64
N_HEADS = (D_MODEL // 2) // HEAD_DIM
N_KV_HEADS = N_HEADS // 8
GQA_GROUP = N_HEADS // N_KV_HEADS
ATTN_WIDTH = N_HEADS * HEAD_DIM
KV_WIDTH = N_KV_HEADS * HEAD_DIM
WINDOW = 128
BLOCK = WINDOW
SPLITS = (POOL_WIDTH, POOL_WIDTH, ATTN_WIDTH, KV_WIDTH, KV_WIDTH, ATTN_WIDTH, D_MODEL, D_MODEL)
N_IN = sum(SPLITS)
DEEPNORM_ALPHA = (2.0 * DEPTH) ** 0.25
DEEPNORM_BETA = (8.0 * DEPTH) ** -0.25
LN_EPS = 1e-5

kernel_name = "hybrid_pool_swa_gated_decoder_step"


def _alibi_slopes():
    h = jnp.arange(N_HEADS, dtype=jnp.float32)
    return (2.0 ** (-8.0 * (h + 1.0) / N_HEADS)).reshape(N_KV_HEADS, GQA_GROUP)


def _project_in(x, w_in):
    proj = jnp.einsum('btd,dn->btn', x, w_in)
    idx = np.cumsum(SPLITS)[:-1].tolist()
    return jnp.split(proj, idx, axis=-1)


def _pool_mixer(u_ext, start_pos, n_new, w_pool, pool_scale):
    b = u_ext.shape[0]
    uf = u_ext.astype(jnp.float32)
    csum = jnp.concatenate([jnp.zeros((b, 1, POOL_WIDTH), jnp.float32), jnp.cumsum(uf, axis=1)], axis=1)
    end = csum[:, POOL_STATE + 1:]
    u_new = uf[:, POOL_STATE:]
    pos = start_pos + jnp.arange(n_new)
    outs = []
    for g, w in enumerate(POOL_WINDOWS):
        sl = slice(g * POOL_GROUP_WIDTH, (g + 1) * POOL_GROUP_WIDTH)
        begin = csum[:, POOL_STATE + 1 - w: POOL_STATE + 1 - w + n_new, sl]
        count = jnp.minimum(w, pos + 1).astype(jnp.float32)[None, :, None]
        outs.append((end[..., sl] - begin) / count - u_new[..., sl])
    pooled = jnp.stack(outs, axis=2).astype(u_ext.dtype)
    mixed = jnp.einsum('btgc,gce->btge', pooled, w_pool)
    return mixed.reshape(b, n_new, POOL_WIDTH) * pool_scale


def _window_attention(q, k, v, dist, valid, slopes, sinks):
    logits = jnp.einsum('bntkgd,bnskd->bnkgts', q, k, preferred_element_type=jnp.float32) * (HEAD_DIM ** -0.5)
    logits = logits - slopes[None, None, :, :, None, None] * dist[None, :, None, None, :, :]
    logits = jnp.where(valid[None, :, None, None, :, :], logits, -jnp.inf)
    sink = sinks.astype(jnp.float32).reshape(N_KV_HEADS, GQA_GROUP)[None, None, :, :, None, None]
    m = jnp.maximum(logits.max(axis=-1, keepdims=True), sink)
    p = jnp.exp(logits - m)
    probs = (p / (p.sum(axis=-1, keepdims=True) + jnp.exp(sink - m))).astype(v.dtype)
    return jnp.einsum('bnkgts,bnskd->bntkgd', probs, v)


def _prompt_attention(q, k, v, slopes, sinks):
    b, t = q.shape[:2]
    nb = t // BLOCK
    qb = q.reshape(b, nb, BLOCK, N_KV_HEADS, GQA_GROUP, HEAD_DIM)

    def band(a):
        prev = jnp.pad(a, ((0, 0), (BLOCK, 0), (0, 0), (0, 0)))[:, :t]
        return jnp.concatenate([prev.reshape(b, nb, BLOCK, N_KV_HEADS, HEAD_DIM),
                                a.reshape(b, nb, BLOCK, N_KV_HEADS, HEAD_DIM)], axis=2)

    qi = jnp.arange(BLOCK)[:, None]
    kj = jnp.arange(2 * BLOCK)[None, :]
    dist = BLOCK + qi - kj
    key_pos = (jnp.arange(nb)[:, None, None] - 1) * BLOCK + kj[None]
    valid = (dist >= 0) & (dist < WINDOW) & (key_pos >= 0)
    out = _window_attention(qb, band(k), band(v), dist[None].astype(jnp.float32), valid, slopes, sinks)
    return out.reshape(b, t, ATTN_WIDTH)


def _sample_attention(q, k_all, v_all, slopes, sinks):
    b, t = q.shape[:2]
    s = k_all.shape[1]
    qi = jnp.arange(t)[:, None]
    kj = jnp.arange(s)[None, :]
    dist = WINDOW + qi - kj
    key_pos = PAST_LEN - WINDOW + kj
    valid = (dist >= 0) & (dist < WINDOW) & (key_pos >= 0)
    qb = q.reshape(b, 1, t, N_KV_HEADS, GQA_GROUP, HEAD_DIM)
    out = _window_attention(qb, k_all[:, None], v_all[:, None], dist[None].astype(jnp.float32), valid[None], slopes, sinks)
    return out.reshape(b, t, ATTN_WIDTH)


def _layer_norm(x, g, b):
    xf = x.astype(jnp.float32)
    mu = xf.mean(axis=-1, keepdims=True)
    var = jnp.square(xf - mu).mean(axis=-1, keepdims=True)
    return ((xf - mu) * lax.rsqrt(var + LN_EPS) * g + b).astype(x.dtype)


def _merge_and_norm(x, pool_out, z_a, attn_out, z_b, g_a, g_b, w_out_pool, w_out_attn, w_out, ln_gain, ln_bias):
    y_a = jnp.einsum('btc,cd->btd', jax.nn.silu(z_a) * pool_out, w_out_pool)
    y_b = jnp.einsum('btc,cd->btd', jax.nn.silu(z_b) * attn_out, w_out_attn)
    h = jax.nn.sigmoid(g_a) * y_a + jax.nn.sigmoid(g_b) * y_b
    out = jnp.einsum('btc,cd->btd', h, w_out)
    return _layer_norm(DEEPNORM_ALPHA * x + out, ln_gain, ln_bias)


def setup_inputs(seed: int = 0) -> dict:
    key = jax.random.key(seed)
    ks = jax.random.split(key, 16)
    f32 = jnp.float32
    v_start = sum(SPLITS[:4])
    col_scale = np.ones((N_IN,), np.float32)
    col_scale[v_start:v_start + KV_WIDTH] = DEEPNORM_BETA
    return {
        "x_prompt": jax.random.normal(ks[0], (BATCH, SEQ, D_MODEL), f32),
        "x_sample": jax.random.normal(ks[1], (DEC_BATCH, DEC_SEQ, D_MODEL), f32),
        "cache_k": jax.random.normal(ks[2], (DEPTH, DEC_BATCH, WINDOW, N_KV_HEADS, HEAD_DIM), f32),
        "cache_v": jax.random.normal(ks[3], (DEPTH, DEC_BATCH, WINDOW, N_KV_HEADS, HEAD_DIM), f32) * DEEPNORM_BETA,
        "state_pool": jax.random.normal(ks[4], (DEPTH, DEC_BATCH, POOL_STATE, POOL_WIDTH), f32),
        "w_in": jax.random.normal(ks[5], (DEPTH, D_MODEL, N_IN), f32) * (D_MODEL ** -0.5) * jnp.asarray(col_scale),
        "w_pool": jax.random.normal(ks[6], (DEPTH, POOL_GROUPS, POOL_GROUP_WIDTH, POOL_GROUP_WIDTH), f32) * (POOL_GROUP_WIDTH ** -0.5),
        "pool_scale": 1.0 + 0.02 * jax.random.normal(ks[7], (DEPTH, POOL_WIDTH), f32),
        "sinks": 0.5 * jax.random.normal(ks[8], (DEPTH, N_HEADS), f32),
        "w_out_pool": jax.random.normal(ks[9], (DEPTH, POOL_WIDTH, D_MODEL), f32) * (POOL_WIDTH ** -0.5) * DEEPNORM_BETA,
        "w_out_attn": jax.random.normal(ks[10], (DEPTH, ATTN_WIDTH, D_MODEL), f32) * (ATTN_WIDTH ** -0.5) * DEEPNORM_BETA,
        "w_out": jax.random.normal(ks[11], (DEPTH, D_MODEL, D_MODEL), f32) * (D_MODEL ** -0.5) * DEEPNORM_BETA,
        "ln_gain": 1.0 + 0.02 * jax.random.normal(ks[12], (DEPTH, D_MODEL), f32),
        "ln_bias": 0.02 * jax.random.normal(ks[13], (DEPTH, D_MODEL), f32),
    }


def reference(x_prompt, x_sample, cache_k, cache_v, state_pool, w_in, w_pool, pool_scale, sinks,
              w_out_pool, w_out_attn, w_out, ln_gain, ln_bias):
    slopes = _alibi_slopes()
    xp, xs = x_prompt, x_sample
    bp, tp = xp.shape[:2]
    bs, ts = xs.shape[:2]
    kp_l, vp_l, pp_l, ks_l, vs_l, ps_l = [], [], [], [], [], []
    for l in range(DEPTH):
        u, z_a, q, k, v, z_b, g_a, g_b = _project_in(xp, w_in[l])
        k = k.reshape(bp, tp, N_KV_HEADS, HEAD_DIM)
        v = v.reshape(bp, tp, N_KV_HEADS, HEAD_DIM)
        u_ext = jnp.concatenate([jnp.zeros((bp, POOL_STATE, POOL_WIDTH), u.dtype), u], axis=1)
        pool_out = _pool_mixer(u_ext, 0, tp, w_pool[l], pool_scale[l])
        attn_out = _prompt_attention(q, k, v, slopes, sinks[l])
        kp_l.append(k[:, -WINDOW:])
        vp_l.append(v[:, -WINDOW:])
        pp_l.append(u_ext[:, -POOL_STATE:])
        xp = _merge_and_norm(xp, pool_out, z_a, attn_out, z_b, g_a, g_b,
                             w_out_pool[l], w_out_attn[l], w_out[l], ln_gain[l], ln_bias[l])

        u, z_a, q, k, v, z_b, g_a, g_b = _project_in(xs, w_in[l])
        k = k.reshape(bs, ts, N_KV_HEADS, HEAD_DIM)
        v = v.reshape(bs, ts, N_KV_HEADS, HEAD_DIM)
        u_ext = jnp.concatenate([state_pool[l].astype(u.dtype), u], axis=1)
        pool_out = _pool_mixer(u_ext, PAST_LEN, ts, w_pool[l], pool_scale[l])
        k_all = jnp.concatenate([cache_k[l].astype(k.dtype), k], axis=1)
        v_all = jnp.concatenate([cache_v[l].astype(v.dtype), v], axis=1)
        attn_out = _sample_attention(q, k_all, v_all, slopes, sinks[l])
        ks_l.append(k_all[:, -WINDOW:])
        vs_l.append(v_all[:, -WINDOW:])
        ps_l.append(u_ext[:, -POOL_STATE:])
        xs = _merge_and_norm(xs, pool_out, z_a, attn_out, z_b, g_a, g_b,
                             w_out_pool[l], w_out_attn[l], w_out[l], ln_gain[l], ln_bias[l])
    return (xp, xs, jnp.stack(kp_l), jnp.stack(vp_l), jnp.stack(pp_l),
            jnp.stack(ks_l), jnp.stack(vs_l), jnp.stack(ps_l))
```

```cpp
#include <hip/hip_runtime.h>
#include <hip/hip_cooperative_groups.h>
#include <cstdio>
#include <cstdint>
namespace cg = cooperative_groups;

#define LAS __attribute__((address_space(3)))
typedef unsigned short bf16_t;
typedef short bf16x8 __attribute__((ext_vector_type(8)));
typedef float f32x4 __attribute__((ext_vector_type(4)));
typedef float f32x2 __attribute__((ext_vector_type(2)));
typedef unsigned u32x4 __attribute__((ext_vector_type(4)));
typedef unsigned u32x2 __attribute__((ext_vector_type(2)));
typedef __bf16 bf16x2_t __attribute__((ext_vector_type(2)));

constexpr int D = 4096, MP = 8192, MS = 1024, MT = 9216, NIN = 16896, PW = 2048;
constexpr int C_U = 0, C_ZA = 2048, C_Q = 4096, C_K = 6144, C_V = 6400, C_ZB = 6656, C_GA = 8704, C_GB = 12800;
constexpr int NWAVES = 8, NTHREADS = 512;
constexpr int LDS_BYTES = 131072;
constexpr float DN_ALPHA = 1.189207115002721f;
constexpr float LN_EPS = 1e-5f;

constexpr size_t WS_XB = 0;
constexpr size_t WS_WIN = WS_XB + (size_t)MT * D * 2;
constexpr size_t WS_WCAT = WS_WIN + (size_t)NIN * D * 2;
constexpr size_t WS_WOUT = WS_WCAT + (size_t)D * D * 2;
constexpr size_t WS_WP = WS_WOUT + (size_t)D * D * 2;
constexpr size_t WS_PROJ = WS_WP + (size_t)4 * 512 * 512 * 2;
constexpr size_t WS_POOL = WS_PROJ + (size_t)MT * NIN * 2;
constexpr size_t WS_ACAT = WS_POOL + (size_t)MT * PW * 2;
constexpr size_t WS_H = WS_ACAT + (size_t)MT * D * 2;
constexpr size_t WS_END = WS_H + (size_t)MT * D * 2;

constexpr size_t O_Y = 0;
constexpr size_t O_KP = (size_t)MT * D;
constexpr size_t O_VP = O_KP + 2 * 128 * 256;
constexpr size_t O_PP = O_VP + 2 * 128 * 256;
constexpr size_t O_KS = O_PP + 2 * 15 * 2048;
constexpr size_t O_VS = O_KS + (size_t)128 * 128 * 256;
constexpr size_t O_PS = O_VS + (size_t)128 * 128 * 256;
constexpr size_t O_END = O_PS + (size_t)128 * 15 * 2048;

#define LDS_WAIT() asm volatile("s_waitcnt lgkmcnt(0)" ::: "memory")
#define CFENCE() asm volatile("" ::: "memory")

__device__ __forceinline__ unsigned pk2(float lo, float hi) { f32x2 v = {lo, hi}; bf16x2_t r = __builtin_convertvector(v, bf16x2_t); return __builtin_bit_cast(unsigned, r); }
__device__ __forceinline__ float bf_lo(unsigned w) { return __uint_as_float(w << 16); }
__device__ __forceinline__ float bf_hi(unsigned w) { return __uint_as_float(w & 0xffff0000u); }
__device__ __forceinline__ float sigm(float x) { return __builtin_amdgcn_rcpf(1.0f + __expf(-x)); }
__device__ __forceinline__ float wave_sum(float v) {
#pragma unroll
    for (int o = 1; o < 64; o <<= 1) v += __shfl_xor(v, o);
    return v;
}

constexpr int BM = 256, BK = 64, HALF = 128, HTB = HALF * BK * 2, NXCD = 8, WGM = 8;
__device__ __forceinline__ int lds_byte(int r, int c) { const int st = (r >> 4) * 2 + (c >> 5), rr = r & 15, cc = c & 31, ob = rr * 64 + cc * 2; return st * 1024 + (ob ^ (((ob >> 9) & 1) << 5)); }
__device__ __forceinline__ void stage_rc(int b, int& R, int& C) { const int st = b / 1024, sb = b % 1024, swz = sb ^ (((sb >> 9) & 1) << 5); R = (st >> 1) * 16 + swz / 64; C = (st & 1) * 32 + (swz % 64) / 2; }
__device__ __forceinline__ int perm32(int rho) { const int n = rho >> 4, i = rho & 15; return 8 * (i >> 2) + 4 * n + (i & 3); }

struct Unit { int pm, pn; };
struct GemmDesc { const char* A; const char* B; int lda, ldb, K, nM, nN, agrp; };
__device__ __forceinline__ bool unit_next(const GemmDesc& g, int i, int G, int c, Unit& u) {
    const int nwg = g.nM * g.nN; const long L = (long)i * G + c; if (L >= nwg) return false;
    int wgid = (int)L; { const int q = nwg / NXCD, r = nwg % NXCD, xcd = wgid % NXCD, off = wgid / NXCD; wgid = (xcd < r ? xcd * (q + 1) : r * (q + 1) + (xcd - r) * q) + off; }
    const int nig = WGM * g.nN, gid = wgid / nig, fm = gid * WGM, gsz = (g.nM - fm) < WGM ? (g.nM - fm) : WGM;
    u.pm = fm + ((wgid % nig) % gsz); u.pn = (wgid % nig) / gsz; return true;
}

template <class Epi>
__device__ __forceinline__ void gemm_phase(LAS unsigned char* lds, const GemmDesc g, const Epi& E) {
    const int tid = threadIdx.x, wid = __builtin_amdgcn_readfirstlane(tid >> 6), lane = tid & 63, wr = wid >> 2, wc = wid & 3, fr = lane & 15, fq = lane >> 4;
    const int nt = g.K / BK; const int G = gridDim.x, cidx = blockIdx.x;
    unsigned voffA[2], voffB[2];
#pragma unroll
    for (int i = 0; i < 2; ++i) { int R, C; stage_rc(tid * 16 + i * 8192, R, C); const int Rb = Epi::PERM ? ((R & ~31) + perm32(R & 31)) : R;
        voffA[i] = (unsigned)(R * g.lda + C) * 2u; voffB[i] = (unsigned)(Rb * g.ldb + C) * 2u; }
    const size_t kstep = (size_t)(BK * 2);
    const size_t hstepA = (size_t)HALF * g.lda * 2, hstepB = (size_t)HALF * g.ldb * 2;
    const unsigned ldsw = (unsigned)wid * 1024u;
    const int aoff = lds_byte(wr * 64 + fr, fq * 8), boff = lds_byte(wc * 32 + fr, fq * 8);
#define PG8_SA(b, h) (((b) * 2 + (h)) * HTB)
#define PG8_SB(b, h) ((4 + (b) * 2 + (h)) * HTB)
#define PG8_STAGE(bufoff, gbase, voff) do { _Pragma("unroll") for (int _i = 0; _i < 2; ++_i) \
        __builtin_amdgcn_global_load_lds((const unsigned*)((const char*)(gbase) + (voff)[_i]), (LAS unsigned*)(lds + (bufoff) + ldsw + _i * 8192), 16, 0, 0); } while (0)
#define PG8_LDA(dst, b, h) do { _Pragma("unroll") for (int m = 0; m < 4; ++m) _Pragma("unroll") for (int k = 0; k < 2; ++k) dst[m][k] = *(const LAS bf16x8*)(lds + PG8_SA(b, h) + aoff + m * 2048 + k * 1024); } while (0)
#define PG8_LDB(dst, b, h) do { _Pragma("unroll") for (int n = 0; n < 2; ++n) _Pragma("unroll") for (int k = 0; k < 2; ++k) dst[n][k] = *(const LAS bf16x8*)(lds + PG8_SB(b, h) + boff + n * 2048 + k * 1024); } while (0)
#define PG8_MMA(ai, bj, At, Bt) do { __builtin_amdgcn_s_setprio(1); _Pragma("unroll") for (int m = 0; m < 4; ++m) _Pragma("unroll") for (int n = 0; n < 2; ++n) _Pragma("unroll") for (int k = 0; k < 2; ++k) \
        acc[ai][bj][m][n] = __builtin_amdgcn_mfma_f32_16x16x32_bf16(Bt[n][k], At[m][k], acc[ai][bj][m][n], 0, 0, 0); __builtin_amdgcn_s_setprio(0); } while (0)
#define PG8_WAIT_V(n) asm volatile("s_waitcnt vmcnt(" #n ")" ::: "memory")
#define PG8_WAIT_L(n) asm volatile("s_waitcnt lgkmcnt(" #n ")" ::: "memory")
#define PG8_BAR __builtin_amdgcn_s_barrier()
#define PG8_SCHED __builtin_amdgcn_sched_barrier(0)
    Unit cur, nxt; int ui = 0;
    if (!unit_next(g, 0, G, cidx, cur)) return;
    f32x4 acc[2][2][4][2];
#pragma unroll
    for (int a = 0; a < 2; ++a)
#pragma unroll
        for (int b = 0; b < 2; ++b)
#pragma unroll
            for (int m = 0; m < 4; ++m)
#pragma unroll
                for (int n = 0; n < 2; ++n) acc[a][b][m][n] = (f32x4){0.f, 0.f, 0.f, 0.f};
    bf16x8 At[4][2], B0[2][2], B1[2][2];
    const char* cA = g.A + (size_t)cur.pm * 2 * hstepA + (g.agrp ? (size_t)(cur.pn >> 1) * 1024 : 0);
    const char* cB = g.B + (size_t)cur.pn * 2 * hstepB;
    PG8_STAGE(PG8_SB(0, 0), cB, voffB); PG8_STAGE(PG8_SB(0, 1), cB + hstepB, voffB); PG8_STAGE(PG8_SA(0, 0), cA, voffA); PG8_STAGE(PG8_SA(0, 1), cA + hstepA, voffA);
    if (wr == 1) PG8_BAR;
    PG8_WAIT_V(2); PG8_BAR;
    PG8_STAGE(PG8_SB(1, 0), cB + kstep, voffB); PG8_STAGE(PG8_SA(1, 0), cA + kstep, voffA); PG8_STAGE(PG8_SB(1, 1), cB + hstepB + kstep, voffB);
    PG8_WAIT_V(6); PG8_BAR;
    for (;;) {
        const bool has_next = unit_next(g, ui + 1, G, cidx, nxt);
        const char* nA = has_next ? g.A + (size_t)nxt.pm * 2 * hstepA + (g.agrp ? (size_t)(nxt.pn >> 1) * 1024 : 0) : cA;
        const char* nB = has_next ? g.B + (size_t)nxt.pn * 2 * hstepB : cB;
        for (int t = 0; t < nt; t += 2) {
            const bool last = (t == nt - 2);
            const char* a1 = cA + (size_t)(t + 1) * kstep;
            const char* a2 = last ? nA : cA + (size_t)(t + 2) * kstep; const char* b2 = last ? nB : cB + (size_t)(t + 2) * kstep;
            const char* a3 = a2 + kstep; const char* b3 = b2 + kstep;
            if constexpr (Epi::MID) { if (t == (nt >> 1)) E.mid(acc, cur, wr, wc, fr, fq); }
            PG8_LDB(B0, 0, 0); PG8_LDB(B1, 0, 1); PG8_SCHED; PG8_LDA(At, 0, 0); PG8_STAGE(PG8_SA(1, 1), a1 + hstepA, voffA);
            PG8_WAIT_V(8); PG8_WAIT_L(0); PG8_BAR; PG8_MMA(0, 0, At, B0); PG8_MMA(0, 1, At, B1); PG8_BAR; PG8_SCHED;
            PG8_LDA(At, 0, 1); PG8_STAGE(PG8_SB(0, 0), b2, voffB); PG8_STAGE(PG8_SB(0, 1), b2 + hstepB, voffB); PG8_STAGE(PG8_SA(0, 0), a2, voffA);
            PG8_WAIT_V(8); PG8_WAIT_L(0); PG8_BAR; PG8_MMA(1, 0, At, B0); PG8_MMA(1, 1, At, B1); PG8_BAR; PG8_SCHED;
            PG8_LDB(B0, 1, 0); PG8_LDB(B1, 1, 1); PG8_SCHED; PG8_LDA(At, 1, 0); PG8_STAGE(PG8_SA(0, 1), a2 + hstepA, voffA);
            PG8_WAIT_V(8); PG8_WAIT_L(0); PG8_BAR; PG8_MMA(0, 0, At, B0); PG8_MMA(0, 1, At, B1); PG8_BAR; PG8_SCHED;
            PG8_LDA(At, 1, 1); PG8_STAGE(PG8_SB(1, 0), b3, voffB); PG8_STAGE(PG8_SB(1, 1), b3 + hstepB, voffB); PG8_STAGE(PG8_SA(1, 0), a3, voffA);
            PG8_WAIT_V(8); PG8_WAIT_L(0); PG8_BAR; PG8_MMA(1, 0, At, B0); PG8_MMA(1, 1, At, B1); PG8_BAR; PG8_SCHED;
        }
        if (wr == 0) PG8_BAR;
        E(acc, cur, wr, wc, fr, fq);
        if (!has_next) break;
#pragma unroll
        for (int a = 0; a < 2; ++a)
#pragma unroll
            for (int b = 0; b < 2; ++b)
#pragma unroll
                for (int m = 0; m < 4; ++m)
#pragma unroll
                    for (int n = 0; n < 2; ++n) acc[a][b][m][n] = (f32x4){0.f, 0.f, 0.f, 0.f};
        cur = nxt; cA = nA; cB = nB; ++ui;
        if (wr == 1) PG8_BAR;
    }
    PG8_WAIT_V(0);
    PG8_BAR;
#undef PG8_SA
#undef PG8_SB
#undef PG8_STAGE
#undef PG8_LDA
#undef PG8_LDB
#undef PG8_MMA
#undef PG8_WAIT_V
#undef PG8_WAIT_L
#undef PG8_BAR
#undef PG8_SCHED
}

typedef f32x4 AccT[2][2][4][2];

struct EpiProj {
    static constexpr bool PERM = true, MID = false;
    bf16_t* O;
    __device__ __forceinline__ void mid(AccT&, const Unit&, int, int, int, int) const {}
    __device__ __forceinline__ void operator()(const AccT& acc, const Unit& u, int wr, int wc, int fr, int fq) const {
        const int row0 = u.pm * BM + wr * 64 + fr, col0 = u.pn * BM + wc * 32 + 8 * fq;
        const int act = ((u.pn >= 8 && u.pn < 16) || (u.pn >= 26 && u.pn < 34)) ? 1 : (u.pn >= 34 ? 2 : 0);
#pragma unroll
        for (int ai = 0; ai < 2; ++ai)
#pragma unroll
            for (int m = 0; m < 4; ++m) { bf16_t* rowp = O + (size_t)(row0 + ai * HALF + m * 16) * NIN + col0;
#pragma unroll
                for (int bj = 0; bj < 2; ++bj) { f32x4 v0 = acc[ai][bj][m][0], v1 = acc[ai][bj][m][1];
                    if (act) {
#pragma unroll
                        for (int j = 0; j < 4; ++j) { const float s0 = sigm(v0[j]), s1 = sigm(v1[j]); v0[j] = act == 1 ? v0[j] * s0 : s0; v1[j] = act == 1 ? v1[j] * s1 : s1; } }
                    u32x4 w; w.x = pk2(v0[0], v0[1]); w.y = pk2(v0[2], v0[3]); w.z = pk2(v1[0], v1[1]); w.w = pk2(v1[2], v1[3]);
                    *(u32x4*)(rowp + bj * HALF) = w; } }
    }
};
struct EpiPool {
    static constexpr bool PERM = true, MID = false;
    bf16_t* O; const bf16_t* Proj; const float* pscale;
    __device__ __forceinline__ void mid(AccT&, const Unit&, int, int, int, int) const {}
    __device__ __forceinline__ void operator()(const AccT& acc, const Unit& u, int wr, int wc, int fr, int fq) const {
        const int row0 = u.pm * BM + wr * 64 + fr, col0 = u.pn * BM + wc * 32 + 8 * fq;
        f32x4 ps[2][2];
#pragma unroll
        for (int bj = 0; bj < 2; ++bj) { ps[bj][0] = *(const f32x4*)(pscale + col0 + bj * HALF); ps[bj][1] = *(const f32x4*)(pscale + col0 + bj * HALF + 4); }
#pragma unroll
        for (int ai = 0; ai < 2; ++ai)
#pragma unroll
            for (int m = 0; m < 4; ++m) { const size_t row = (size_t)(row0 + ai * HALF + m * 16);
#pragma unroll
                for (int bj = 0; bj < 2; ++bj) { const u32x4 z = *(const u32x4*)(Proj + row * NIN + C_ZA + col0 + bj * HALF);
                    const f32x4 v0 = acc[ai][bj][m][0] * ps[bj][0], v1 = acc[ai][bj][m][1] * ps[bj][1];
                    u32x4 w; w.x = pk2(v0[0] * bf_lo(z.x), v0[1] * bf_hi(z.x)); w.y = pk2(v0[2] * bf_lo(z.y), v0[3] * bf_hi(z.y));
                    w.z = pk2(v1[0] * bf_lo(z.z), v1[1] * bf_hi(z.z)); w.w = pk2(v1[2] * bf_lo(z.w), v1[3] * bf_hi(z.w));
                    *(u32x4*)(O + row * D + col0 + bj * HALF) = w; }
                CFENCE(); }
    }
};
struct EpiGate {
    static constexpr bool PERM = true, MID = true;
    bf16_t* O; const bf16_t* Proj;
    __device__ __forceinline__ void mid(AccT& acc, const Unit& u, int wr, int wc, int fr, int fq) const {
        int row0 = u.pm * BM + wr * 64 + fr; const int col0 = u.pn * BM + wc * 32 + 8 * fq;
        asm volatile("" : "+v"(row0) :: "memory");
#pragma unroll
        for (int ai = 0; ai < 2; ++ai)
#pragma unroll
            for (int m = 0; m < 4; ++m) { const bf16_t* gp = Proj + (size_t)(row0 + ai * HALF + m * 16) * NIN + col0;
#pragma unroll
                for (int bj = 0; bj < 2; ++bj) { const u32x4 a = *(const u32x4*)(gp + C_GA + bj * HALF), b = *(const u32x4*)(gp + C_GB + bj * HALF);
                    f32x4 r0, r1;
                    r0[0] = bf_lo(a.x) * __builtin_amdgcn_rcpf(bf_lo(b.x)); r0[1] = bf_hi(a.x) * __builtin_amdgcn_rcpf(bf_hi(b.x));
                    r0[2] = bf_lo(a.y) * __builtin_amdgcn_rcpf(bf_lo(b.y)); r0[3] = bf_hi(a.y) * __builtin_amdgcn_rcpf(bf_hi(b.y));
                    r1[0] = bf_lo(a.z) * __builtin_amdgcn_rcpf(bf_lo(b.z)); r1[1] = bf_hi(a.z) * __builtin_amdgcn_rcpf(bf_hi(b.z));
                    r1[2] = bf_lo(a.w) * __builtin_amdgcn_rcpf(bf_lo(b.w)); r1[3] = bf_hi(a.w) * __builtin_amdgcn_rcpf(bf_hi(b.w));
                    acc[ai][bj][m][0] = acc[ai][bj][m][0] * r0; acc[ai][bj][m][1] = acc[ai][bj][m][1] * r1; }
                CFENCE(); }
    }
    __device__ __forceinline__ void operator()(const AccT& acc, const Unit& u, int wr, int wc, int fr, int fq) const {
        const int row0 = u.pm * BM + wr * 64 + fr, col0 = u.pn * BM + wc * 32 + 8 * fq;
#pragma unroll
        for (int ai = 0; ai < 2; ++ai)
#pragma unroll
            for (int m = 0; m < 4; ++m) { const size_t row = (size_t)(row0 + ai * HALF + m * 16);
#pragma unroll
                for (int bj = 0; bj < 2; ++bj) { const u32x4 b = *(const u32x4*)(Proj + row * NIN + C_GB + col0 + bj * HALF);
                    const f32x4 v0 = acc[ai][bj][m][0], v1 = acc[ai][bj][m][1];
                    u32x4 w; w.x = pk2(v0[0] * bf_lo(b.x), v0[1] * bf_hi(b.x)); w.y = pk2(v0[2] * bf_lo(b.y), v0[3] * bf_hi(b.y));
                    w.z = pk2(v1[0] * bf_lo(b.z), v1[1] * bf_hi(b.z)); w.w = pk2(v1[2] * bf_lo(b.w), v1[3] * bf_hi(b.w));
                    *(u32x4*)(O + row * D + col0 + bj * HALF) = w; }
                CFENCE(); }
    }
};
struct EpiOut {
    static constexpr bool PERM = false, MID = false;
    float* Y; const float* xp; const float* xs;
    __device__ __forceinline__ void mid(AccT&, const Unit&, int, int, int, int) const {}
    __device__ __forceinline__ void operator()(const AccT& acc, const Unit& u, int wr, int wc, int fr, int fq) const {
        const int row0 = u.pm * BM + wr * 64 + fr, col0 = u.pn * BM + wc * 32 + 4 * fq;
        const float* xb = (u.pm < 32) ? xp : xs - (size_t)MP * D;
#pragma unroll
        for (int ai = 0; ai < 2; ++ai)
#pragma unroll
            for (int m = 0; m < 4; ++m) { const size_t off = (size_t)(row0 + ai * HALF + m * 16) * D + col0;
#pragma unroll
                for (int bj = 0; bj < 2; ++bj)
#pragma unroll
                    for (int n = 0; n < 2; ++n) { const f32x4 xv = *(const f32x4*)(xb + off + bj * HALF + n * 16);
                        *(f32x4*)(Y + off + bj * HALF + n * 16) = xv * DN_ALPHA + acc[ai][bj][m][n]; }
                CFENCE(); }
    }
};

__device__ __forceinline__ void p0_transpose_item(const float* __restrict__ W, int N, bf16_t* __restrict__ WT, int ldd, int koff, LAS unsigned* scr, int kb, int nb, int lane) {
    const int rp = lane >> 4, c4 = lane & 15;
    const float* src = W + (size_t)(64 * kb + 2 * rp) * N + 64 * nb + 4 * c4;
    f32x4 a[8], b[8];
#pragma unroll
    for (int i = 0; i < 8; ++i) { a[i] = *(const f32x4*)(src + (size_t)(8 * i) * N); b[i] = *(const f32x4*)(src + (size_t)(8 * i + 1) * N); }
#pragma unroll
    for (int i = 0; i < 8; ++i) { const int kd = 4 * i + rp;
#pragma unroll
        for (int j = 0; j < 4; ++j) scr[(4 * c4 + j) * 33 + kd] = pk2(a[i][j], b[i][j]); }
    LDS_WAIT();
    const int c = lane & 7;
#pragma unroll
    for (int jj = 0; jj < 8; ++jj) { const int n = (lane >> 3) + 8 * jj; const LAS unsigned* s = scr + n * 33 + 4 * c;
        u32x4 o; o.x = s[0]; o.y = s[1]; o.z = s[2]; o.w = s[3];
        *(u32x4*)(WT + (size_t)(64 * nb + n) * ldd + koff + 64 * kb + 8 * c) = o; }
    LDS_WAIT();
}

struct Args { const float* in[14]; float* out; unsigned char* ws; int ph_lo, ph_hi; };

__device__ __forceinline__ void phase0(const Args& A, LAS unsigned char* lds) {
    const int lane = threadIdx.x & 63, wave = threadIdx.x >> 6;
    const int gw = blockIdx.x * NWAVES + wave, NGW = gridDim.x * NWAVES;
    LAS unsigned* scr = (LAS unsigned*)(lds + wave * 8704);
    bf16_t* WinT = (bf16_t*)(A.ws + WS_WIN); bf16_t* WcatT = (bf16_t*)(A.ws + WS_WCAT); bf16_t* WoutT = (bf16_t*)(A.ws + WS_WOUT); bf16_t* WpT = (bf16_t*)(A.ws + WS_WP);
    constexpr int I_IN = (D / 64) * (NIN / 64), I_OP = (PW / 64) * (D / 64), I_OUT = (D / 64) * (D / 64), I_WP = 4 * 8 * 8;
    constexpr int NITEMS = I_IN + 2 * I_OP + I_OUT + I_WP;
    for (int it = gw; it < NITEMS; it += NGW) {
        int r = it;
        if (r < I_IN) { const int nbk = NIN / 64; p0_transpose_item(A.in[5], NIN, WinT, D, 0, scr, r / nbk, r % nbk, lane); continue; } r -= I_IN;
        if (r < I_OP) { p0_transpose_item(A.in[9], D, WcatT, D, 0, scr, r / 64, r % 64, lane); continue; } r -= I_OP;
        if (r < I_OP) { p0_transpose_item(A.in[10], D, WcatT, D, PW, scr, r / 64, r % 64, lane); continue; } r -= I_OP;
        if (r < I_OUT) { p0_transpose_item(A.in[11], D, WoutT, D, 0, scr, r / 64, r % 64, lane); continue; } r -= I_OUT;
        { const int g = r >> 6, q = r & 63; p0_transpose_item(A.in[6] + (size_t)g * 512 * 512, 512, WpT + (size_t)g * 512 * 512, 512, 0, scr, q >> 3, q & 7, lane); }
    }
    bf16_t* Xb = (bf16_t*)(A.ws + WS_XB);
    for (int r = gw; r < MT; r += NGW) {
        const float* src = (r < MP) ? A.in[0] + (size_t)r * D : A.in[1] + (size_t)(r - MP) * D;
        bf16_t* dst = Xb + (size_t)r * D;
#pragma unroll
        for (int it = 0; it < 8; ++it) { const f32x4 v0 = *(const f32x4*)(src + 512 * it + 8 * lane), v1 = *(const f32x4*)(src + 512 * it + 8 * lane + 4);
            u32x4 o; o.x = pk2(v0[0], v0[1]); o.y = pk2(v0[2], v0[3]); o.z = pk2(v1[0], v1[1]); o.w = pk2(v1[2], v1[3]);
            *(u32x4*)(dst + 512 * it + 8 * lane) = o; }
    }
}

constexpr int KS_PITCH = 144, VT_PITCH = 528, KS_BYTES = 256 * KS_PITCH, VT_BYTES = 64 * VT_PITCH;
#define MFMA16(a, b, c) __builtin_amdgcn_mfma_f32_16x16x32_bf16((a), (b), (c), 0, 0, 0)

__device__ __forceinline__ void attn_qtile(LAS const unsigned char* Ks, LAS const unsigned char* Vt, int kt0, int row, int h, int qi, int jmin,
                                           const bf16_t* Proj, bf16_t* Acat, const float* sinks, int lane) {
    const int c = lane & 15, quad = lane >> 4;
    const bf16_t* qp = Proj + (size_t)row * NIN + C_Q + h * 64 + quad * 8;
    const bf16x8 q0 = *(const bf16x8*)qp, q1 = *(const bf16x8*)(qp + 32);
    f32x4 s[9];
#pragma unroll
    for (int t = 0; t < 9; ++t) {
        LAS const unsigned char* kp = Ks + ((kt0 + t) * 16 + c) * KS_PITCH + quad * 16;
        const bf16x8 k0 = *(LAS const bf16x8*)kp, k1 = *(LAS const bf16x8*)(kp + 64);
        f32x4 z = {0.f, 0.f, 0.f, 0.f};
        z = MFMA16(k0, q0, z); z = MFMA16(k1, q1, z); s[t] = z;
    }
    const float slope = exp2f(-0.25f * (float)(h + 1)), sink = sinks[h];
    float mx = sink;
#pragma unroll
    for (int t = 0; t < 9; ++t)
#pragma unroll
        for (int e = 0; e < 4; ++e) { const int j = (kt0 + t) * 16 + 4 * quad + e; const int dist = 128 + qi - j;
            const bool ok = (dist >= 0) && (dist < 128) && (j >= jmin);
            const float v = ok ? (s[t][e] * 0.125f - slope * (float)dist) : -INFINITY; s[t][e] = v; mx = fmaxf(mx, v); }
    mx = fmaxf(mx, __shfl_xor(mx, 16)); mx = fmaxf(mx, __shfl_xor(mx, 32));
    float sum = 0.f;
#pragma unroll
    for (int t = 0; t < 9; ++t)
#pragma unroll
        for (int e = 0; e < 4; ++e) { const float p = __expf(s[t][e] - mx); s[t][e] = p; sum += p; }
    sum += __shfl_xor(sum, 16); sum += __shfl_xor(sum, 32);
    const float inv = 1.0f / (sum + __expf(sink - mx));
    f32x4 o[4];
#pragma unroll
    for (int dt = 0; dt < 4; ++dt) o[dt] = (f32x4){0.f, 0.f, 0.f, 0.f};
#pragma unroll
    for (int si = 0; si < 5; ++si) { const int t0 = 2 * si, t1 = 2 * si + 1;
        u32x4 pb; pb.x = pk2(s[t0][0], s[t0][1]); pb.y = pk2(s[t0][2], s[t0][3]);
        if (t1 < 9) { pb.z = pk2(s[t1 < 9 ? t1 : 0][0], s[t1 < 9 ? t1 : 0][1]); pb.w = pk2(s[t1 < 9 ? t1 : 0][2], s[t1 < 9 ? t1 : 0][3]); } else { pb.z = 0u; pb.w = 0u; }
        const bf16x8 pfrag = __builtin_bit_cast(bf16x8, pb);
#pragma unroll
        for (int dt = 0; dt < 4; ++dt) {
            LAS const unsigned char* vp = Vt + (dt * 16 + c) * VT_PITCH + ((kt0 + t0) * 16 + 4 * quad) * 2;
            const u32x2 va = *(LAS const u32x2*)vp; u32x2 vb = {0u, 0u};
            if (t1 < 9) vb = *(LAS const u32x2*)(vp + 32);
            u32x4 av; av.x = va.x; av.y = va.y; av.z = vb.x; av.w = vb.y;
            o[dt] = MFMA16(__builtin_bit_cast(bf16x8, av), pfrag, o[dt]);
        }
    }
    const bf16_t* zp = Proj + (size_t)row * NIN + C_ZB + h * 64 + 4 * quad;
    bf16_t* op = Acat + (size_t)row * D + PW + h * 64 + 4 * quad;
#pragma unroll
    for (int dt = 0; dt < 4; ++dt) { const u32x2 z = *(const u32x2*)(zp + 16 * dt);
        u32x2 w; w.x = pk2(o[dt][0] * inv * bf_lo(z.x), o[dt][1] * inv * bf_hi(z.x)); w.y = pk2(o[dt][2] * inv * bf_lo(z.y), o[dt][3] * inv * bf_hi(z.y));
        *(u32x2*)(op + 16 * dt) = w; }
}

__device__ __forceinline__ void store_kv_lds(LAS unsigned char* Ks, LAS unsigned char* Vt, int j, int cc, u32x4 kv, u32x4 vv) {
    *(LAS u32x4*)(Ks + j * KS_PITCH + cc * 16) = kv;
    LAS unsigned short* vt = (LAS unsigned short*)(Vt + (cc * 8) * VT_PITCH + j * 2);
    constexpr int P2 = VT_PITCH / 2;
    vt[0 * P2] = (unsigned short)(vv.x & 0xffffu); vt[1 * P2] = (unsigned short)(vv.x >> 16);
    vt[2 * P2] = (unsigned short)(vv.y & 0xffffu); vt[3 * P2] = (unsigned short)(vv.y >> 16);
    vt[4 * P2] = (unsigned short)(vv.z & 0xffffu); vt[5 * P2] = (unsigned short)(vv.z >> 16);
    vt[6 * P2] = (unsigned short)(vv.w & 0xffffu); vt[7 * P2] = (unsigned short)(vv.w >> 16);
}

__device__ __forceinline__ void phase2(const Args& A, LAS unsigned char* lds) {
    const int tid = threadIdx.x, lane = tid & 63, wave = tid >> 6, G = gridDim.x;
    const bf16_t* Proj = (const bf16_t*)(A.ws + WS_PROJ); bf16_t* Acat = (bf16_t*)(A.ws + WS_ACAT); bf16_t* Pooled = (bf16_t*)(A.ws + WS_POOL);
    const float* sinks = A.in[8];
    LAS unsigned char* Ks = lds; LAS unsigned char* Vt = lds + KS_BYTES;
    for (int item = blockIdx.x; item < 256; item += G) {
        const int kvh = item & 3, nb = (item >> 2) & 31, b = item >> 7;
        const int tok0 = b * 4096 + (nb - 1) * 128;
        for (int id = tid; id < 2048; id += NTHREADS) { const int j = id >> 3, cc = id & 7;
            u32x4 kv = {0u, 0u, 0u, 0u}, vv = {0u, 0u, 0u, 0u};
            if (nb > 0 || j >= 128) { const bf16_t* p = Proj + (size_t)(tok0 + j) * NIN + kvh * 64 + cc * 8; kv = *(const u32x4*)(p + C_K); vv = *(const u32x4*)(p + C_V); }
            store_kv_lds(Ks, Vt, j, cc, kv, vv); }
        __syncthreads();
        const int h = kvh * 8 + wave, jmin = nb > 0 ? 0 : 128;
        for (int qt = 0; qt < 8; ++qt) { const int qi = qt * 16 + (lane & 15);
            attn_qtile(Ks, Vt, qt, b * 4096 + nb * 128 + qi, h, qi, jmin, Proj, Acat, sinks, lane); }
        __syncthreads();
    }
    for (int item = blockIdx.x; item < 512; item += G) {
        const int kvh = item & 3, b = item >> 2;
        for (int id = tid; id < 144 * 8; id += NTHREADS) { const int j = id >> 3, cc = id & 7;
            u32x4 kv = {0u, 0u, 0u, 0u}, vv = {0u, 0u, 0u, 0u};
            if (j < 128) { const size_t o = ((size_t)(b * 128 + j) * 4 + kvh) * 64 + cc * 8;
                const f32x4 k0 = *(const f32x4*)(A.in[2] + o), k1 = *(const f32x4*)(A.in[2] + o + 4), v0 = *(const f32x4*)(A.in[3] + o), v1 = *(const f32x4*)(A.in[3] + o + 4);
                kv.x = pk2(k0[0], k0[1]); kv.y = pk2(k0[2], k0[3]); kv.z = pk2(k1[0], k1[1]); kv.w = pk2(k1[2], k1[3]);
                vv.x = pk2(v0[0], v0[1]); vv.y = pk2(v0[2], v0[3]); vv.z = pk2(v1[0], v1[1]); vv.w = pk2(v1[2], v1[3]); }
            else if (j < 136) { const bf16_t* p = Proj + (size_t)(MP + b * 8 + (j - 128)) * NIN + kvh * 64 + cc * 8; kv = *(const u32x4*)(p + C_K); vv = *(const u32x4*)(p + C_V); }
            store_kv_lds(Ks, Vt, j, cc, kv, vv); }
        __syncthreads();
        if (wave < 4) { const int c = lane & 15, tok = c & 7, h = kvh * 8 + 2 * wave + (c >> 3);
            attn_qtile(Ks, Vt, 0, MP + b * 8 + tok, h, tok, 0, Proj, Acat, sinks, lane); }
        __syncthreads();
    }
    for (int idx = blockIdx.x * NTHREADS + tid; idx < MT * 256; idx += G * NTHREADS) {
        const int r = idx >> 8, cg8 = idx & 255, c = cg8 * 8, w = 2 << (cg8 >> 6);
        float a[8], cur[8];
#pragma unroll
        for (int e = 0; e < 8; ++e) { a[e] = 0.f; cur[e] = 0.f; }
        float inv;
        if (r < MP) { const int t = r & 4095, n = (w < t + 1) ? w : t + 1; inv = 1.0f / (float)n;
            for (int x = 0; x < n; ++x) { const u32x4 v = *(const u32x4*)(Proj + (size_t)(r - x) * NIN + C_U + c);
                const float f[8] = {bf_lo(v.x), bf_hi(v.x), bf_lo(v.y), bf_hi(v.y), bf_lo(v.z), bf_hi(v.z), bf_lo(v.w), bf_hi(v.w)};
#pragma unroll
                for (int e = 0; e < 8; ++e) { a[e] += f[e]; if (x == 0) cur[e] = f[e]; } }
        } else { const int rs = r - MP, b = rs >> 3, t = rs & 7; inv = 1.0f / (float)w;
            for (int x = 0; x < w; ++x) { const int ee = 15 + t - x; float f[8];
                if (ee >= 15) { const u32x4 v = *(const u32x4*)(Proj + (size_t)(MP + b * 8 + ee - 15) * NIN + C_U + c);
                    f[0] = bf_lo(v.x); f[1] = bf_hi(v.x); f[2] = bf_lo(v.y); f[3] = bf_hi(v.y); f[4] = bf_lo(v.z); f[5] = bf_hi(v.z); f[6] = bf_lo(v.w); f[7] = bf_hi(v.w); }
                else { const float* sp = A.in[4] + ((size_t)(b * 15 + ee)) * PW + c; const f32x4 s0 = *(const f32x4*)sp, s1 = *(const f32x4*)(sp + 4);
                    f[0] = s0[0]; f[1] = s0[1]; f[2] = s0[2]; f[3] = s0[3]; f[4] = s1[0]; f[5] = s1[1]; f[6] = s1[2]; f[7] = s1[3]; }
#pragma unroll
                for (int e = 0; e < 8; ++e) { a[e] += f[e]; if (x == 0) cur[e] = f[e]; } }
        }
        u32x4 o; o.x = pk2(a[0] * inv - cur[0], a[1] * inv - cur[1]); o.y = pk2(a[2] * inv - cur[2], a[3] * inv - cur[3]);
        o.z = pk2(a[4] * inv - cur[4], a[5] * inv - cur[5]); o.w = pk2(a[6] * inv - cur[6], a[7] * inv - cur[7]);
        *(u32x4*)(Pooled + (size_t)r * PW + c) = o;
    }
    float* out = A.out;
    const int gt = blockIdx.x * NTHREADS + tid, GT = G * NTHREADS;
    auto ld4 = [&](const bf16_t* p) { const u32x2 v = *(const u32x2*)p; return (f32x4){bf_lo(v.x), bf_hi(v.x), bf_lo(v.y), bf_hi(v.y)}; };
    for (int i = gt; i < 2 * 128 * 64; i += GT) { const int c4 = (i & 63) * 4, j = (i >> 6) & 127, b = i >> 13;
        const bf16_t* p = Proj + (size_t)(b * 4096 + 3968 + j) * NIN + c4;
        *(f32x4*)(out + O_KP + (size_t)i * 4) = ld4(p + C_K); *(f32x4*)(out + O_VP + (size_t)i * 4) = ld4(p + C_V); }
    for (int i = gt; i < 2 * 15 * 512; i += GT) { const int c4 = (i & 511) * 4, x = (i >> 9) % 15, b = i / (15 * 512);
        *(f32x4*)(out + O_PP + (size_t)i * 4) = ld4(Proj + (size_t)(b * 4096 + 4081 + x) * NIN + C_U + c4); }
    for (int i = gt; i < 128 * 128 * 64; i += GT) { const int c4 = (i & 63) * 4, j = (i >> 6) & 127, b = i >> 13;
        f32x4 kx, vx;
        if (j < 120) { const size_t o = ((size_t)(b * 128 + j + 8)) * 256 + c4; kx = *(const f32x4*)(A.in[2] + o); vx = *(const f32x4*)(A.in[3] + o); }
        else { const bf16_t* p = Proj + (size_t)(MP + b * 8 + (j - 120)) * NIN + c4; kx = ld4(p + C_K); vx = ld4(p + C_V); }
        *(f32x4*)(out + O_KS + (size_t)i * 4) = kx; *(f32x4*)(out + O_VS + (size_t)i * 4) = vx; }
    for (int i = gt; i < 128 * 15 * 512; i += GT) { const int c4 = (i & 511) * 4, x = (i >> 9) % 15, b = i / (15 * 512);
        f32x4 v;
        if (x < 7) v = *(const f32x4*)(A.in[4] + ((size_t)(b * 15 + x + 8)) * PW + c4);
        else v = ld4(Proj + (size_t)(MP + b * 8 + (x - 7)) * NIN + C_U + c4);
        *(f32x4*)(out + O_PS + (size_t)i * 4) = v; }
}

__device__ __forceinline__ void phase_ln(const Args& A) {
    const int lane = threadIdx.x & 63, wave = threadIdx.x >> 6;
    const int gw = blockIdx.x * NWAVES + wave, NGW = gridDim.x * NWAVES;
    const float* gain = A.in[12]; const float* bias = A.in[13];
    for (int r = gw; r < MT; r += NGW) {
        float* y = A.out + O_Y + (size_t)r * D + 4 * lane;
        f32x4 v[16]; float s = 0.f;
#pragma unroll
        for (int j = 0; j < 16; ++j) { v[j] = *(const f32x4*)(y + 256 * j); s += (v[j][0] + v[j][1]) + (v[j][2] + v[j][3]); }
        const float mean = wave_sum(s) * (1.0f / D); float q = 0.f;
#pragma unroll
        for (int j = 0; j < 16; ++j) { v[j] = v[j] - mean; q += (v[j][0] * v[j][0] + v[j][1] * v[j][1]) + (v[j][2] * v[j][2] + v[j][3] * v[j][3]); }
        const float rstd = 1.0f / sqrtf(wave_sum(q) * (1.0f / D) + LN_EPS);
#pragma unroll
        for (int j = 0; j < 16; ++j) { const f32x4 g4 = *(const f32x4*)(gain + 256 * j + 4 * lane), b4 = *(const f32x4*)(bias + 256 * j + 4 * lane);
            *(f32x4*)(y + 256 * j) = v[j] * rstd * g4 + b4; }
    }
}

constexpr int NPH = 7;
__global__ void __launch_bounds__(NTHREADS, 2) fwd_megakernel(Args A) {
    extern __shared__ __attribute__((aligned(16))) unsigned char smem[];
    LAS unsigned char* lds = (LAS unsigned char*)smem;
    cg::grid_group grid = cg::this_grid();
#define PH_ON(k) (A.ph_lo <= (k) && (k) < A.ph_hi)
#define PH_SYNC(k) do { if (A.ph_lo < (k) && (k) < A.ph_hi) grid.sync(); } while (0)
    if (PH_ON(0)) phase0(A, lds);
    PH_SYNC(1);
    if (PH_ON(1)) { GemmDesc g{(const char*)(A.ws + WS_XB), (const char*)(A.ws + WS_WIN), D, D, D, MT / BM, NIN / BM, 0};
        EpiProj E{(bf16_t*)(A.ws + WS_PROJ)}; gemm_phase(lds, g, E); }
    PH_SYNC(2);
    if (PH_ON(2)) phase2(A, lds);
    PH_SYNC(3);
    if (PH_ON(3)) { GemmDesc g{(const char*)(A.ws + WS_POOL), (const char*)(A.ws + WS_WP), PW, 512, 512, MT / BM, PW / BM, 1};
        EpiPool E{(bf16_t*)(A.ws + WS_ACAT), (const bf16_t*)(A.ws + WS_PROJ), A.in[7]}; gemm_phase(lds, g, E); }
    PH_SYNC(4);
    if (PH_ON(4)) { GemmDesc g{(const char*)(A.ws + WS_ACAT), (const char*)(A.ws + WS_WCAT), D, D, D, MT / BM, D / BM, 0};
        EpiGate E{(bf16_t*)(A.ws + WS_H), (const bf16_t*)(A.ws + WS_PROJ)}; gemm_phase(lds, g, E); }
    PH_SYNC(5);
    if (PH_ON(5)) { GemmDesc g{(const char*)(A.ws + WS_H), (const char*)(A.ws + WS_WOUT), D, D, D, MT / BM, D / BM, 0};
        EpiOut E{A.out + O_Y, A.in[0], A.in[1]}; gemm_phase(lds, g, E); }
    PH_SYNC(6);
    if (PH_ON(6)) phase_ln(A);
}

extern "C" void kernel_launch(void* const* d_in, const int* in_sizes, int n_in, void* d_out, int out_size, void* d_ws, size_t ws_size, hipStream_t stream) {
    static int grid = 0;
    if (grid == 0) {
        if (n_in != 14 || (size_t)out_size != O_END || ws_size < WS_END) { fprintf(stderr, "kernel_launch: unexpected shapes (n_in %d out %d ws %zu)\n", n_in, out_size, ws_size); grid = -1; return; }
        int dev = 0, cus = 0, per_cu = 0;
        hipGetDevice(&dev); hipDeviceGetAttribute(&cus, hipDeviceAttributeMultiprocessorCount, dev);
        if (hipFuncSetAttribute((const void*)fwd_megakernel, hipFuncAttributeMaxDynamicSharedMemorySize, LDS_BYTES) != hipSuccess) { fprintf(stderr, "kernel_launch: hipFuncSetAttribute failed\n"); grid = -1; return; }
        if (hipOccupancyMaxActiveBlocksPerMultiprocessor(&per_cu, (const void*)fwd_megakernel, NTHREADS, LDS_BYTES) != hipSuccess || per_cu < 1) { fprintf(stderr, "kernel_launch: occupancy query says %d blocks per CU\n", per_cu); grid = -1; return; }
        grid = cus;
    }
    if (grid < 0) return;
    Args a{};
    for (int i = 0; i < 14; ++i) a.in[i] = (const float*)d_in[i];
    a.out = (float*)d_out; a.ws = (unsigned char*)d_ws; a.ph_lo = 0; a.ph_hi = NPH;
    void* args[] = {&a};
    hipError_t e = hipLaunchCooperativeKernel((const void*)fwd_megakernel, dim3(grid), dim3(NTHREADS), args, LDS_BYTES, stream);
    if (e != hipSuccess) fprintf(stderr, "cooperative launch failed: %s (grid %d)\n", hipGetErrorString(e), grid);
}
```
